# Optimizing an MI355X kernel written in HIP

```python
import math
import jax
import jax.numpy as jnp
from jax import lax
import numpy as np

D_MODEL = 1024
BATCH = 32
SEQ = 2048
DEPTH = 2

GRID_W = 64
CTX_LEN = 256
MIX_W = D_MODEL
N_MIXERS = 4
GROUP_W = MIX_W // N_MIXERS
DA_HEADS = 4
DA_HD = GROUP_W // DA_HEADS // 2
DA_VD = 2 * DA_HD
QBLOCK = 128
ROPE_BASE = 10000.0
HG_HEADS = 4
HG_HD = GROUP_W // HG_HEADS
HG_CHUNK = 16
SC_WIDTH = 3
S5_GROUP = 16
S5_NGROUPS = GROUP_W // S5_GROUP
S5_STATE = 64
FFN_HIDDEN = ((8 * D_MODEL + 3 * 256 - 1) // (3 * 256)) * 256
IN_COLS = 12 * GROUP_W
EPS = 1e-6

kernel_name = 'hybrid_parallel_heads_flow_block'


def rmsnorm(x, g):
    xf = x.astype(jnp.float32)
    xf = xf * lax.rsqrt(jnp.mean(xf * xf, axis=-1, keepdims=True) + EPS)
    return xf.astype(x.dtype) * g


def modulate(h, shift, scale):
    return h * (1 + scale) + shift


def swiglu(h, w_in, w_out):
    gate, up = jnp.split(h @ w_in, 2, axis=-1)
    return (jax.nn.silu(gate) * up) @ w_out


def axial_rope_tables(n_rows):
    rows = jnp.broadcast_to(jnp.arange(n_rows, dtype=jnp.float32)[:, None], (n_rows, GRID_W)).reshape(-1)
    cols = jnp.broadcast_to(jnp.arange(GRID_W, dtype=jnp.float32)[None, :], (n_rows, GRID_W)).reshape(-1)
    n_freq = DA_HD // 4
    inv = ROPE_BASE ** (-jnp.arange(n_freq, dtype=jnp.float32) / n_freq)
    ang = jnp.concatenate([rows[:, None] * inv, cols[:, None] * inv], axis=-1)
    return jnp.cos(ang), jnp.sin(ang)


def apply_rope(x, cos, sin):
    xf = x.astype(jnp.float32)
    x1, x2 = xf[..., 0::2], xf[..., 1::2]
    out = jnp.stack([x1 * cos - x2 * sin, x1 * sin + x2 * cos], axis=-1)
    return out.reshape(x.shape).astype(x.dtype)


def _qk_heads(a):
    b, t, _ = a.shape
    return a.reshape(b, t, DA_HEADS, 2, DA_HD).transpose(0, 2, 3, 1, 4)


def _v_heads(a):
    b, t, _ = a.shape
    return a.reshape(b, t, DA_HEADS, DA_VD).transpose(0, 2, 1, 3)


def diff_attend(q, k, v, lam):
    s = jnp.einsum('bhmqd,bhmkd->bhmqk', q, k).astype(jnp.float32) * (DA_HD ** -0.5)
    p = jax.nn.softmax(s, axis=-1)
    a = (p[:, :, 0] - lam * p[:, :, 1]).astype(v.dtype)
    return jnp.einsum('bhqk,bhkv->bqhv', a, v)


def diff_attention_mixer(px, pc, cos, sin, lam_vecs, subln_g, layer_idx, want_ctx_out):
    lam_init = 0.8 - 0.6 * math.exp(-0.3 * layer_idx)
    lv = lam_vecs.astype(jnp.float32)
    lam = jnp.exp(jnp.sum(lv[0] * lv[1])) - jnp.exp(jnp.sum(lv[2] * lv[3])) + lam_init

    def finish(o):
        b, t = o.shape[0], o.shape[1]
        return (rmsnorm(o, subln_g) * (1.0 - lam_init)).reshape(b, t, GROUP_W)

    qx = apply_rope(_qk_heads(px[0]), cos, sin)
    kx = apply_rope(_qk_heads(px[1]), cos, sin)
    kc, vc = _qk_heads(pc[1]), _v_heads(pc[2])
    keys = jnp.concatenate([kx, kc], axis=3)
    vals = jnp.concatenate([_v_heads(px[2]), vc], axis=2)
    b, h, _, t, d = qx.shape
    nb = t // QBLOCK
    q_blocks = qx.reshape(b, h, 2, nb, QBLOCK, d).transpose(3, 0, 1, 2, 4, 5)
    o_x = lax.map(lambda qb: diff_attend(qb, keys, vals, lam), q_blocks)
    out_x = finish(o_x.transpose(1, 0, 2, 3, 4).reshape(b, t, DA_HEADS, DA_VD))
    out_c = finish(diff_attend(_qk_heads(pc[0]), kc, vc, lam)) if want_ctx_out else None
    return out_x, out_c


def hgrn2_chunk_scan(q, k, v, log_f, s0, want_out):
    b, h, t, dk = k.shape
    n = t // HG_CHUNK

    def chunks(a):
        return a.reshape(b, h, n, HG_CHUNK, a.shape[-1]).transpose(2, 0, 1, 3, 4)

    kc, vc = chunks(k), chunks(v)
    G = jnp.cumsum(chunks(log_f), axis=-2)
    g_tot = G[..., -1, :]
    k_end = kc * jnp.exp(g_tot[..., None, :] - G)
    dec = jnp.exp(g_tot)
    if not want_out:
        def step_state(S, inp):
            d_n, k_n, v_n = inp
            return d_n[..., None] * S + jnp.einsum('bhjk,bhjv->bhkv', k_n, v_n), None
        s_fin, _ = lax.scan(step_state, s0, (dec, k_end, vc))
        return None, s_fin
    q_dec = chunks(q) * jnp.exp(G)
    k_inv = kc * jnp.exp(-G)
    mask = jnp.tril(jnp.ones((HG_CHUNK, HG_CHUNK), dtype=bool))
    A = jnp.where(mask, jnp.einsum('nbhik,nbhjk->nbhij', q_dec, k_inv), 0.0)
    o_intra = jnp.einsum('nbhij,nbhjv->nbhiv', A, vc)

    def step(S, inp):
        d_n, k_n, v_n, q_n = inp
        o_n = jnp.einsum('bhik,bhkv->bhiv', q_n, S)
        return d_n[..., None] * S + jnp.einsum('bhjk,bhjv->bhkv', k_n, v_n), o_n

    s_fin, o_inter = lax.scan(step, s0, (dec, k_end, vc, q_dec))
    o = (o_intra + o_inter).transpose(1, 2, 0, 3, 4).reshape(b, h, t, v.shape[-1])
    return o, s_fin


def _hg_heads(a):
    b, t, _ = a.shape
    return a.astype(jnp.float32).reshape(b, t, HG_HEADS, HG_HD).transpose(0, 2, 1, 3)


def _hg_gate(f_raw, lb):
    lb = lb.reshape(HG_HEADS, 1, HG_HD)
    f = lb + (1.0 - lb) * jax.nn.sigmoid(_hg_heads(f_raw))
    return 1.0 - f, jnp.log(f)


def _tflip(a):
    return jnp.flip(a, axis=2)


def hgrn2_mixer(px, pc, lb, norm_g, want_ctx_out):
    b = px[0].shape[0]
    s0 = jnp.zeros((b, HG_HEADS, HG_HD, HG_HD), jnp.float32)
    kcf, lcf = _hg_gate(pc[1], lb[0])
    kcb, lcb = _hg_gate(pc[2], lb[1])
    ic = _hg_heads(pc[3])
    qc = jax.nn.silu(_hg_heads(pc[0])) if want_ctx_out else None
    oc_f, s_f = hgrn2_chunk_scan(qc, kcf, ic, lcf, s0, want_ctx_out)
    oc_b, s_b = hgrn2_chunk_scan(_tflip(qc) if want_ctx_out else None, _tflip(kcb), _tflip(ic), _tflip(lcb), s0, want_ctx_out)
    kxf, lxf = _hg_gate(px[1], lb[0])
    kxb, lxb = _hg_gate(px[2], lb[1])
    ix = _hg_heads(px[3])
    qx = jax.nn.silu(_hg_heads(px[0]))
    ox_f, _ = hgrn2_chunk_scan(qx, kxf, ix, lxf, s_f, True)
    ox_b, _ = hgrn2_chunk_scan(_tflip(qx), _tflip(kxb), _tflip(ix), _tflip(lxb), s_b, True)

    def finish(o, g_raw):
        bb, t = g_raw.shape[0], g_raw.shape[1]
        o = rmsnorm(o.transpose(0, 2, 1, 3), norm_g.astype(jnp.float32))
        o = o * jax.nn.silu(g_raw.astype(jnp.float32).reshape(bb, t, HG_HEADS, HG_HD))
        return o.reshape(bb, t, GROUP_W).astype(g_raw.dtype)

    out_x = finish(ox_f + _tflip(ox_b), px[4])
    out_c = finish(oc_f + _tflip(oc_b), pc[4]) if want_ctx_out else None
    return out_x, out_c


def short_conv_mixer(p, w, bias):
    b_gate, c_gate, u = p
    v = c_gate * u
    y = lax.conv_general_dilated(v, w[:, None, :].astype(v.dtype), window_strides=(1,),
                                 padding=((SC_WIDTH // 2, SC_WIDTH // 2),),
                                 dimension_numbers=('NWC', 'WIO', 'NWC'),
                                 feature_group_count=GROUP_W)
    return b_gate * (y + bias)


def s5_discretise(a_re, a_im, log_dt, b_re, b_im):
    dt = jnp.exp(log_dt)[:, None]
    mag = jnp.exp(dt * a_re)
    ab_re, ab_im = mag * jnp.cos(dt * a_im), mag * jnp.sin(dt * a_im)
    den = a_re * a_re + a_im * a_im
    nr = ab_re - 1.0
    f_re = (nr * a_re + ab_im * a_im) / den
    f_im = (ab_im * a_re - nr * a_im) / den
    bb_re = f_re[..., None] * b_re - f_im[..., None] * b_im
    bb_im = f_re[..., None] * b_im + f_im[..., None] * b_re
    return ab_re, ab_im, bb_re, bb_im


def _complex_affine_combine(e1, e2):
    a1r, a1i, b1r, b1i = e1
    a2r, a2i, b2r, b2i = e2
    return (a2r * a1r - a2i * a1i, a2r * a1i + a2i * a1r,
            a2r * b1r - a2i * b1i + b2r, a2r * b1i + a2i * b1r + b2i)


def s5_scan(u, ab_re, ab_im, bb_re, bb_im, x0_re, x0_im):
    bu_re = jnp.einsum('btgp,gnp->btgn', u, bb_re)
    bu_im = jnp.einsum('btgp,gnp->btgn', u, bb_im)
    bu_re = bu_re.at[:, 0].add(ab_re * x0_re - ab_im * x0_im)
    bu_im = bu_im.at[:, 0].add(ab_re * x0_im + ab_im * x0_re)
    a_re = jnp.broadcast_to(ab_re, bu_re.shape)
    a_im = jnp.broadcast_to(ab_im, bu_im.shape)
    _, _, x_re, x_im = lax.associative_scan(_complex_affine_combine, (a_re, a_im, bu_re, bu_im), axis=1)
    return x_re, x_im


def s5_mixer(u_x, u_c, a_re, a_im, log_dt, b_re, b_im, c_re, c_im, d, w_glu, b_glu, want_ctx_out):
    f32 = jnp.float32
    ux = u_x.astype(f32).reshape(u_x.shape[0], u_x.shape[1], S5_NGROUPS, S5_GROUP)
    uc = u_c.astype(f32).reshape(u_c.shape[0], u_c.shape[1], S5_NGROUPS, S5_GROUP)
    zeros = jnp.zeros((ux.shape[0], S5_NGROUPS, S5_STATE), f32)
    d_g = d.astype(f32).reshape(S5_NGROUPS, S5_GROUP)
    y_x = d_g * ux
    y_c = d_g * uc if want_ctx_out else None
    for direction in range(2):
        rev = direction == 1
        disc = s5_discretise(a_re[direction].astype(f32), a_im[direction].astype(f32),
                             log_dt[direction].astype(f32), b_re[direction].astype(f32),
                             b_im[direction].astype(f32))
        cr, ci = c_re[direction].astype(f32), c_im[direction].astype(f32)
        uc_o = jnp.flip(uc, axis=1) if rev else uc
        ux_o = jnp.flip(ux, axis=1) if rev else ux
        xc_re, xc_im = s5_scan(uc_o, *disc, zeros, zeros)
        xx_re, xx_im = s5_scan(ux_o, *disc, xc_re[:, -1], xc_im[:, -1])
        yx = jnp.einsum('btgn,gpn->btgp', xx_re, cr) - jnp.einsum('btgn,gpn->btgp', xx_im, ci)
        y_x = y_x + (jnp.flip(yx, axis=1) if rev else yx)
        if want_ctx_out:
            yc = jnp.einsum('btgn,gpn->btgp', xc_re, cr) - jnp.einsum('btgn,gpn->btgp', xc_im, ci)
            y_c = y_c + (jnp.flip(yc, axis=1) if rev else yc)

    def glu(y, dtype):
        y = jax.nn.gelu(y.reshape(y.shape[0], y.shape[1], GROUP_W))
        return (y * jax.nn.sigmoid(y @ w_glu.astype(f32) + b_glu.astype(f32))).astype(dtype)

    out_c = glu(y_c, u_c.dtype) if want_ctx_out else None
    return glu(y_x, u_x.dtype), out_c


def setup_inputs(seed: int = 0) -> dict:
    key = jax.random.key(seed)
    ks = jax.random.split(key, 27)
    f32 = jnp.float32
    L = DEPTH

    def nrm(k, shape, s):
        return jax.random.normal(k, shape, f32) * s

    return {
        'x': nrm(ks[0], (BATCH, SEQ, D_MODEL), 1.0),
        'c': nrm(ks[1], (BATCH, D_MODEL), 1.0),
        'ctx': nrm(ks[2], (BATCH, CTX_LEN, D_MODEL), 1.0),
        'c_ctx': nrm(ks[3], (D_MODEL,), 1.0),
        'w_ada': nrm(ks[4], (L, D_MODEL, 6 * D_MODEL), 0.5 * D_MODEL ** -0.5),
        'b_ada': nrm(ks[5], (L, 6 * D_MODEL), 0.02),
        'norm_g': 1.0 + nrm(ks[6], (L, 4, D_MODEL), 0.05),
        'w_in': nrm(ks[7], (L, D_MODEL, IN_COLS), D_MODEL ** -0.5),
        'w_out': nrm(ks[8], (L, MIX_W, D_MODEL), MIX_W ** -0.5),
        'da_lambda': nrm(ks[9], (L, 4, DA_HD), 0.1),
        'da_subln': 1.0 + nrm(ks[10], (L, DA_VD), 0.05),
        'hg_lb': nrm(ks[11], (L, 2, GROUP_W), 0.5),
        'hg_norm': 1.0 + nrm(ks[12], (L, HG_HD), 0.05),
        'sc_w': nrm(ks[13], (L, SC_WIDTH, GROUP_W), SC_WIDTH ** -0.5),
        'sc_b': nrm(ks[14], (L, GROUP_W), 0.02),
        's5_a_re': -0.5 + nrm(ks[15], (L, 2, S5_NGROUPS, S5_STATE), 0.02),
        's5_a_im': jnp.pi * jnp.arange(S5_STATE, dtype=f32) + nrm(ks[16], (L, 2, S5_NGROUPS, S5_STATE), 0.02),
        's5_log_dt': jax.random.uniform(ks[17], (L, 2, S5_NGROUPS), f32, math.log(1e-3), math.log(1e-1)),
        's5_b_re': nrm(ks[18], (L, 2, S5_NGROUPS, S5_STATE, S5_GROUP), (2 * S5_GROUP) ** -0.5),
        's5_b_im': nrm(ks[19], (L, 2, S5_NGROUPS, S5_STATE, S5_GROUP), (2 * S5_GROUP) ** -0.5),
        's5_c_re': nrm(ks[20], (L, 2, S5_NGROUPS, S5_GROUP, S5_STATE), (2 * S5_STATE) ** -0.5),
        's5_c_im': nrm(ks[21], (L, 2, S5_NGROUPS, S5_GROUP, S5_STATE), (2 * S5_STATE) ** -0.5),
        's5_d': nrm(ks[22], (L, GROUP_W), 1.0),
        's5_w_glu': nrm(ks[23], (L, GROUP_W, GROUP_W), GROUP_W ** -0.5),
        's5_b_glu': nrm(ks[24], (L, GROUP_W), 0.02),
        'w_ffn_in': nrm(ks[25], (L, D_MODEL, 2 * FFN_HIDDEN), D_MODEL ** -0.5),
        'w_ffn_out': nrm(ks[26], (L, FFN_HIDDEN, D_MODEL), FFN_HIDDEN ** -0.5),
    }


def reference(x, c, ctx, c_ctx, w_ada, b_ada, norm_g, w_in, w_out, da_lambda, da_subln,
              hg_lb, hg_norm, sc_w, sc_b, s5_a_re, s5_a_im, s5_log_dt, s5_b_re, s5_b_im,
              s5_c_re, s5_c_im, s5_d, s5_w_glu, s5_b_glu, w_ffn_in, w_ffn_out):
    n_rows = x.shape[1] // GRID_W
    cos, sin = axial_rope_tables(n_rows)
    lb = jnp.cumsum(jax.nn.softmax(hg_lb.astype(jnp.float32), axis=0), axis=0)
    lb = lb - lb[:1]
    silu_c = jax.nn.silu(c)
    silu_cc = jax.nn.silu(c_ctx)
    h = ctx
    for l in range(DEPTH):
        ctx_out = l < DEPTH - 1
        mod_x = jnp.split((silu_c @ w_ada[l] + b_ada[l])[:, None, :], 6, axis=-1)
        mod_c = jnp.split((silu_cc @ w_ada[l] + b_ada[l])[None, None, :], 6, axis=-1)
        px = jnp.split(modulate(rmsnorm(x, norm_g[l, 0]), mod_x[0], mod_x[1]) @ w_in[l], 12, axis=-1)
        pc = jnp.split(modulate(rmsnorm(h, norm_g[l, 0]), mod_c[0], mod_c[1]) @ w_in[l], 12, axis=-1)
        a_x, a_c = diff_attention_mixer(px[0:3], pc[0:3], cos, sin, da_lambda[l], da_subln[l], l, ctx_out)
        b_x, b_c = hgrn2_mixer(px[3:8], pc[3:8], lb[l], hg_norm[l], ctx_out)
        c_x = short_conv_mixer(px[8:11], sc_w[l], sc_b[l])
        d_x, d_c = s5_mixer(px[11], pc[11], s5_a_re[l], s5_a_im[l], s5_log_dt[l], s5_b_re[l], s5_b_im[l],
                            s5_c_re[l], s5_c_im[l], s5_d[l], s5_w_glu[l], s5_b_glu[l], ctx_out)
        mix_x = jnp.concatenate([a_x, b_x, c_x, d_x], axis=-1) @ w_out[l]
        x = x + mod_x[2] * rmsnorm(mix_x, norm_g[l, 1])
        ffn_x = swiglu(modulate(rmsnorm(x, norm_g[l, 2]), mod_x[3], mod_x[4]), w_ffn_in[l], w_ffn_out[l])
        x = x + mod_x[5] * rmsnorm(ffn_x, norm_g[l, 3])
        if ctx_out:
            c_c = short_conv_mixer(pc[8:11], sc_w[l], sc_b[l])
            mix_c = jnp.concatenate([a_c, b_c, c_c, d_c], axis=-1) @ w_out[l]
            h = h + mod_c[2] * rmsnorm(mix_c, norm_g[l, 1])
            ffn_c = swiglu(modulate(rmsnorm(h, norm_g[l, 2]), mod_c[3], mod_c[4]), w_ffn_in[l], w_ffn_out[l])
            h = h + mod_c[5] * rmsnorm(ffn_c, norm_g[l, 3])
    return x
```

```cpp
#include <hip/hip_runtime.h>
#include <hip/hip_cooperative_groups.h>
#include <cstdio>
#include <cstdint>
namespace cg = cooperative_groups;

#define LAS __attribute__((address_space(3)))
typedef unsigned short bf16_t;
typedef short bf16x8 __attribute__((ext_vector_type(8)));
typedef short s16x4 __attribute__((ext_vector_type(4)));
typedef float f32x4 __attribute__((ext_vector_type(4)));
typedef float f32x2 __attribute__((ext_vector_type(2)));
typedef float f32x16 __attribute__((ext_vector_type(16)));
typedef unsigned u32x4 __attribute__((ext_vector_type(4)));
typedef unsigned u32x2 __attribute__((ext_vector_type(2)));

constexpr int D = 1024, NB = 32, SEQ = 2048, CTX = 256, DEPTH = 2;
constexpr int MX = NB * SEQ, MC = NB * CTX, MT = MX + MC;
constexpr int INC = 3072, FH = 2816;
constexpr float EPS = 1e-6f;
constexpr float QSCALE = 0.17677669529663687f * 1.4426950408889634f;

constexpr size_t MiB = 1u << 20;
constexpr size_t WS_CTL = 0, WS_WIN = 2 * MiB, WS_WOUT = 14 * MiB, WS_WF1 = 18 * MiB, WS_WF2 = 40 * MiB, WS_WGLU = 51 * MiB;
constexpr size_t WS_MOD = 52 * MiB, WS_ROPE = 54 * MiB, WS_S5P = 55 * MiB, WS_PRM = 56 * MiB, WS_HS = 58 * MiB;
constexpr size_t WS_XN = 90 * MiB, WS_P = 234 * MiB, WS_RAW = 666 * MiB, WS_Y = 810 * MiB, WS_Z = 954 * MiB, WS_END = 990 * MiB;
constexpr int LDS_BYTES = 147456, MISC_OFF = 131072;

__device__ __forceinline__ unsigned cvt_pk_bf16(float lo, float hi) { unsigned r; asm volatile("v_cvt_pk_bf16_f32 %0, %1, %2" : "=v"(r) : "v"(lo), "v"(hi)); return r; }
__device__ __forceinline__ float bflo(unsigned u) { return __uint_as_float(u << 16); }
__device__ __forceinline__ float bfhi(unsigned u) { return __uint_as_float(u & 0xffff0000u); }
__device__ __forceinline__ float bf2f(bf16_t h) { return __uint_as_float((unsigned)h << 16); }
__device__ __forceinline__ bf16_t f2bf(float f) { return (bf16_t)(cvt_pk_bf16(f, 0.f) & 0xffffu); }
__device__ __forceinline__ float fexp2(float x) { return __builtin_amdgcn_exp2f(x); }
__device__ __forceinline__ float fexp(float x) { return __builtin_amdgcn_exp2f(x * 1.4426950408889634f); }
__device__ __forceinline__ float frcp(float x) { return __builtin_amdgcn_rcpf(x); }
__device__ __forceinline__ float sigmoidf_(float x) { return frcp(1.f + fexp(-x)); }
__device__ __forceinline__ float siluf_(float x) { return x * sigmoidf_(x); }
__device__ __forceinline__ float wave_sum(float v) {
#pragma unroll
    for (int o = 1; o < 64; o <<= 1) v += __shfl_xor(v, o);
    return v;
}
__device__ __forceinline__ int crow(int r, int hi) { return (r & 3) + 8 * (r >> 2) + 4 * hi; }
__device__ __forceinline__ bf16x8 pack8(float a0, float a1, float a2, float a3, float a4, float a5, float a6, float a7) {
    u32x4 w; w.x = cvt_pk_bf16(a0, a1); w.y = cvt_pk_bf16(a2, a3); w.z = cvt_pk_bf16(a4, a5); w.w = cvt_pk_bf16(a6, a7);
    return __builtin_bit_cast(bf16x8, w);
}
__device__ __forceinline__ s16x4 pack4(f32x4 v) { u32x2 w; w.x = cvt_pk_bf16(v[0], v[1]); w.y = cvt_pk_bf16(v[2], v[3]); return __builtin_bit_cast(s16x4, w); }
__device__ __forceinline__ void sincos_d(double x, double& s, double& c) {
    const double n = rint(x * 0.63661977236758134308);
    const double r = fma(-n, 6.123233995736766e-17, fma(-n, 1.5707963267948966, x));
    const double r2 = r * r;
    double sp = -7.6471637318198164759e-13; sp = fma(sp, r2, 1.6059043836821614599e-10); sp = fma(sp, r2, -2.5052108385441718775e-8); sp = fma(sp, r2, 2.7557319223985890653e-6);
    sp = fma(sp, r2, -1.9841269841269841270e-4); sp = fma(sp, r2, 8.3333333333333333333e-3); sp = fma(sp, r2, -1.6666666666666666667e-1); const double sr = fma(sp * r2, r, r);
    double cp = 4.7794773323873852974e-14; cp = fma(cp, r2, -1.1470745597729724714e-11); cp = fma(cp, r2, 2.0876756987868098979e-9); cp = fma(cp, r2, -2.7557319223985890653e-7);
    cp = fma(cp, r2, 2.4801587301587301587e-5); cp = fma(cp, r2, -1.3888888888888888889e-3); cp = fma(cp, r2, 4.1666666666666666667e-2); cp = fma(cp, r2, -0.5); const double cr = fma(cp, r2, 1.0);
    const int q = ((int)n) & 3;
    s = (q == 0) ? sr : (q == 1) ? cr : (q == 2) ? -sr : -cr;
    c = (q == 0) ? cr : (q == 1) ? -sr : (q == 2) ? -cr : sr;
}

namespace pg8 {
constexpr int BM = 256, BK = 64, HALF = 128, HTB = HALF * BK * 2, STAGE_BYTES = 8 * HTB, NXCD = 8, WGM = 8;
__host__ __device__ __forceinline__ int lds_byte(int r, int c) { const int st = (r >> 4) * 2 + (c >> 5), rr = r & 15, cc = c & 31, ob = rr * 64 + cc * 2; return st * 1024 + (ob ^ (((ob >> 9) & 1) << 5)); }
__host__ __device__ __forceinline__ void stage_rc(int b, int& R, int& C) { const int st = b / 1024, sb = b % 1024, swz = sb ^ (((sb >> 9) & 1) << 5); R = (st >> 1) * 16 + swz / 64; C = (st & 1) * 32 + (swz % 64) / 2; }
__host__ __device__ __forceinline__ int perm32(int rho) { const int n = rho >> 4, i = rho & 15; return 8 * (i >> 2) + 4 * n + (i & 3); }
struct Unit { int pm, pn; };
struct Gemm { const bf16_t* A; const bf16_t* Bt; int M, N, K; };
struct StaticOrder {
    int nM, nN, nwg, G, c;
    __device__ void init(int M, int N, int G_, int c_) { nM = M / BM; nN = N / BM; nwg = nM * nN; G = G_; c = c_; }
    __device__ bool next(int i, Unit& u) const {
        const long L = (long)i * G + c; if (L >= nwg) return false;
        int wgid = (int)L; { const int q = nwg / NXCD, r = nwg % NXCD, xcd = wgid % NXCD, off = wgid / NXCD; wgid = (xcd < r ? xcd * (q + 1) : r * (q + 1) + (xcd - r) * q) + off; }
        const int nig = WGM * nN, gid = wgid / nig, fm = gid * WGM, gsz = (nM - fm) < WGM ? (nM - fm) : WGM;
        u.pm = fm + ((wgid % nig) % gsz); u.pn = (wgid % nig) / gsz; return true;
    }
};
template <class Epi>
__device__ __forceinline__ void gemm_phase(LAS unsigned char* lds, const Gemm g, const StaticOrder& S, const Epi& E) {
    int tid = threadIdx.x; asm volatile("" : "+v"(tid));
    const int wid = __builtin_amdgcn_readfirstlane(tid >> 6), lane = tid & 63, wr = wid >> 2, wc = wid & 3, fr = lane & 15, fq = lane >> 4;
    int K = g.K; asm volatile("" : "+s"(K)); const int nt = K / BK;
    unsigned voffA[2], voffB[2];
#pragma unroll
    for (int i = 0; i < 2; ++i) { int R, C; stage_rc(tid * 16 + i * 8192, R, C); const int Rb = (R & ~31) + perm32(R & 31);
        voffA[i] = (unsigned)(R * K + C) * 2u; voffB[i] = (unsigned)(Rb * K + C) * 2u; }
    const size_t kstep = (size_t)(BK * 2);
    const size_t hstep = (size_t)HALF * K * 2;
    const size_t tstep = 2 * hstep;
    const unsigned ldsw = (unsigned)wid * 1024u;
    const int aoff = lds_byte(wr * 64 + fr, fq * 8), boff = lds_byte(wc * 32 + fr, fq * 8);
#define PG8_SA(b, h) (((b) * 2 + (h)) * HTB)
#define PG8_SB(b, h) ((4 + (b) * 2 + (h)) * HTB)
#define PG8_STAGE(bufoff, gbase, voff) do { _Pragma("unroll") for (int _i = 0; _i < 2; ++_i) \
        __builtin_amdgcn_global_load_lds((const unsigned*)((const char*)(gbase) + (voff)[_i]), (LAS unsigned*)(lds + (bufoff) + ldsw + _i * 8192), 16, 0, 0); } while (0)
#define PG8_LDA(dst, b, h) do { _Pragma("unroll") for (int m = 0; m < 4; ++m) _Pragma("unroll") for (int k = 0; k < 2; ++k) dst[m][k] = *(const LAS bf16x8*)(lds + PG8_SA(b, h) + aoff + m * 2048 + k * 1024); } while (0)
#define PG8_LDB(dst, b, h) do { _Pragma("unroll") for (int n = 0; n < 2; ++n) _Pragma("unroll") for (int k = 0; k < 2; ++k) dst[n][k] = *(const LAS bf16x8*)(lds + PG8_SB(b, h) + boff + n * 2048 + k * 1024); } while (0)
#define PG8_MMA(ai, bj, At, Bt) do { __builtin_amdgcn_s_setprio(1); _Pragma("unroll") for (int m = 0; m < 4; ++m) _Pragma("unroll") for (int n = 0; n < 2; ++n) _Pragma("unroll") for (int k = 0; k < 2; ++k) \
        acc[ai][bj][m][n] = __builtin_amdgcn_mfma_f32_16x16x32_bf16(Bt[n][k], At[m][k], acc[ai][bj][m][n], 0, 0, 0); __builtin_amdgcn_s_setprio(0); } while (0)
#define PG8_WAIT_V(n) asm volatile("s_waitcnt vmcnt(" #n ")" ::: "memory")
#define PG8_WAIT_L(n) asm volatile("s_waitcnt lgkmcnt(" #n ")" ::: "memory")
#define PG8_BAR __builtin_amdgcn_s_barrier()
#define PG8_SCHED __builtin_amdgcn_sched_barrier(0)
    Unit cur, nxt; int ui = 0;
    if (!S.next(0, cur)) return;
    f32x4 acc[2][2][4][2];
#pragma unroll
    for (int a = 0; a < 2; ++a)
#pragma unroll
        for (int b = 0; b < 2; ++b)
#pragma unroll
            for (int m = 0; m < 4; ++m)
#pragma unroll
                for (int n = 0; n < 2; ++n) acc[a][b][m][n] = (f32x4){0.f, 0.f, 0.f, 0.f};
    bf16x8 At[4][2], B0[2][2], B1[2][2];
    const char* cA = (const char*)g.A + (size_t)cur.pm * tstep; const char* cB = (const char*)g.Bt + (size_t)cur.pn * tstep;
    PG8_STAGE(PG8_SB(0, 0), cB, voffB); PG8_STAGE(PG8_SB(0, 1), cB + hstep, voffB); PG8_STAGE(PG8_SA(0, 0), cA, voffA); PG8_STAGE(PG8_SA(0, 1), cA + hstep, voffA);
    if (wr == 1) PG8_BAR;
    PG8_WAIT_V(2); PG8_BAR;
    PG8_STAGE(PG8_SB(1, 0), cB + kstep, voffB); PG8_STAGE(PG8_SA(1, 0), cA + kstep, voffA); PG8_STAGE(PG8_SB(1, 1), cB + hstep + kstep, voffB);
    PG8_WAIT_V(6); PG8_BAR;
    for (;;) {
        const bool has_next = S.next(ui + 1, nxt);
        const char* nA = has_next ? (const char*)g.A + (size_t)nxt.pm * tstep : cA; const char* nB = has_next ? (const char*)g.Bt + (size_t)nxt.pn * tstep : cB;
        for (int t = 0; t < nt; t += 2) {
            const bool last = (t == nt - 2);
            const char* a1 = cA + (size_t)(t + 1) * kstep;
            const char* a2 = last ? nA : cA + (size_t)(t + 2) * kstep; const char* b2 = last ? nB : cB + (size_t)(t + 2) * kstep;
            const char* a3 = a2 + kstep; const char* b3 = b2 + kstep;
            PG8_LDB(B0, 0, 0); PG8_LDB(B1, 0, 1); PG8_SCHED; PG8_LDA(At, 0, 0); PG8_STAGE(PG8_SA(1, 1), a1 + hstep, voffA);
            PG8_WAIT_V(8); PG8_WAIT_L(0); PG8_BAR; PG8_MMA(0, 0, At, B0); PG8_MMA(0, 1, At, B1); PG8_BAR; PG8_SCHED;
            PG8_LDA(At, 0, 1); PG8_STAGE(PG8_SB(0, 0), b2, voffB); PG8_STAGE(PG8_SB(0, 1), b2 + hstep, voffB); PG8_STAGE(PG8_SA(0, 0), a2, voffA);
            PG8_WAIT_V(8); PG8_WAIT_L(0); PG8_BAR; PG8_MMA(1, 0, At, B0); PG8_MMA(1, 1, At, B1); PG8_BAR; PG8_SCHED;
            PG8_LDB(B0, 1, 0); PG8_LDB(B1, 1, 1); PG8_SCHED; PG8_LDA(At, 1, 0); PG8_STAGE(PG8_SA(0, 1), a2 + hstep, voffA);
            PG8_WAIT_V(8); PG8_WAIT_L(0); PG8_BAR; PG8_MMA(0, 0, At, B0); PG8_MMA(0, 1, At, B1); PG8_BAR; PG8_SCHED;
            PG8_LDA(At, 1, 1); PG8_STAGE(PG8_SB(1, 0), b3, voffB); PG8_STAGE(PG8_SB(1, 1), b3 + hstep, voffB); PG8_STAGE(PG8_SA(1, 0), a3, voffA);
            PG8_WAIT_V(8); PG8_WAIT_L(0); PG8_BAR; PG8_MMA(1, 0, At, B0); PG8_MMA(1, 1, At, B1); PG8_BAR; PG8_SCHED;
        }
        if (wr == 0) PG8_BAR;
        E(acc, cur, wr, wc, fr, fq);
        if (!has_next) break;
#pragma unroll
        for (int a = 0; a < 2; ++a)
#pragma unroll
            for (int b = 0; b < 2; ++b)
#pragma unroll
                for (int m = 0; m < 4; ++m)
#pragma unroll
                    for (int n = 0; n < 2; ++n) acc[a][b][m][n] = (f32x4){0.f, 0.f, 0.f, 0.f};
        cur = nxt; cA = nA; cB = nB; ++ui;
        if (wr == 1) PG8_BAR;
    }
    PG8_WAIT_V(0);
    PG8_BAR;
#undef PG8_SA
#undef PG8_SB
#undef PG8_STAGE
#undef PG8_LDA
#undef PG8_LDB
#undef PG8_MMA
#undef PG8_WAIT_V
#undef PG8_WAIT_L
#undef PG8_BAR
#undef PG8_SCHED
}

struct EpiPlain {
    bf16_t* O; int ldc;
    __device__ __forceinline__ void operator()(const f32x4 (&acc)[2][2][4][2], const Unit& u, int wr, int wc, int fr, int fq) const {
        const int row0 = u.pm * BM + wr * 64 + fr, col0 = u.pn * BM + wc * 32 + 8 * fq;
#pragma unroll
        for (int ai = 0; ai < 2; ++ai)
#pragma unroll
            for (int m = 0; m < 4; ++m) { bf16_t* rowp = O + (size_t)(row0 + ai * HALF + m * 16) * ldc + col0;
#pragma unroll
                for (int bj = 0; bj < 2; ++bj) { const f32x4 v0 = acc[ai][bj][m][0], v1 = acc[ai][bj][m][1];
                    u32x4 w; w.x = cvt_pk_bf16(v0[0], v0[1]); w.y = cvt_pk_bf16(v0[2], v0[3]); w.z = cvt_pk_bf16(v1[0], v1[1]); w.w = cvt_pk_bf16(v1[2], v1[3]);
                    *(u32x4*)(rowp + bj * HALF) = w; } }
    }
};
struct EpiInProj {
    bf16_t* O; const float* rc; const float* rs;
    __device__ __forceinline__ void operator()(const f32x4 (&acc)[2][2][4][2], const Unit& u, int wr, int wc, int fr, int fq) const {
        const int row0 = u.pm * BM + wr * 64 + fr, col0 = u.pn * BM + wc * 32 + 8 * fq;
        const bool rope = (u.pn < 2) && (u.pm < MX / BM);
        const float qs = (u.pn == 0) ? QSCALE : 1.f;
#pragma unroll
        for (int ai = 0; ai < 2; ++ai)
#pragma unroll
            for (int m = 0; m < 4; ++m) { const int row = row0 + ai * HALF + m * 16; bf16_t* rowp = O + (size_t)row * INC + col0;
                f32x4 c4 = (f32x4){1.f, 1.f, 1.f, 1.f}, s4 = (f32x4){0.f, 0.f, 0.f, 0.f};
                if (rope) { const int t = row & (SEQ - 1); c4 = *(const f32x4*)(rc + t * 16 + 4 * fq); s4 = *(const f32x4*)(rs + t * 16 + 4 * fq); }
                c4 = c4 * qs; s4 = s4 * qs;
#pragma unroll
                for (int bj = 0; bj < 2; ++bj) { const f32x4 v0 = acc[ai][bj][m][0], v1 = acc[ai][bj][m][1];
                    u32x4 w;
                    w.x = cvt_pk_bf16(v0[0] * c4[0] - v0[1] * s4[0], v0[0] * s4[0] + v0[1] * c4[0]);
                    w.y = cvt_pk_bf16(v0[2] * c4[1] - v0[3] * s4[1], v0[2] * s4[1] + v0[3] * c4[1]);
                    w.z = cvt_pk_bf16(v1[0] * c4[2] - v1[1] * s4[2], v1[0] * s4[2] + v1[1] * c4[2]);
                    w.w = cvt_pk_bf16(v1[2] * c4[3] - v1[3] * s4[3], v1[2] * s4[3] + v1[3] * c4[3]);
                    *(u32x4*)(rowp + bj * HALF) = w; } }
    }
};
struct EpiSwiGLU {
    bf16_t* O;
    __device__ __forceinline__ void operator()(const f32x4 (&acc)[2][2][4][2], const Unit& u, int wr, int wc, int fr, int fq) const {
        const int row0 = u.pm * BM + wr * 64 + fr, col0 = u.pn * HALF + wc * 32 + 8 * fq;
#pragma unroll
        for (int ai = 0; ai < 2; ++ai)
#pragma unroll
            for (int m = 0; m < 4; ++m) { bf16_t* rowp = O + (size_t)(row0 + ai * HALF + m * 16) * FH + col0;
                const f32x4 g0 = acc[ai][0][m][0], g1 = acc[ai][0][m][1], u0 = acc[ai][1][m][0], u1 = acc[ai][1][m][1];
                u32x4 w; w.x = cvt_pk_bf16(siluf_(g0[0]) * u0[0], siluf_(g0[1]) * u0[1]); w.y = cvt_pk_bf16(siluf_(g0[2]) * u0[2], siluf_(g0[3]) * u0[3]);
                w.z = cvt_pk_bf16(siluf_(g1[0]) * u1[0], siluf_(g1[1]) * u1[1]); w.w = cvt_pk_bf16(siluf_(g1[2]) * u1[2], siluf_(g1[3]) * u1[3]);
                *(u32x4*)rowp = w; }
    }
};
struct EpiGLU {
    bf16_t* MIX; const bf16_t* Zb; const float* bias;
    __device__ __forceinline__ void operator()(const f32x4 (&acc)[2][2][4][2], const Unit& u, int wr, int wc, int fr, int fq) const {
        const int row0 = u.pm * BM + wr * 64 + fr, col0 = wc * 32 + 8 * fq;
#pragma unroll
        for (int ai = 0; ai < 2; ++ai)
#pragma unroll
            for (int m = 0; m < 4; ++m) { const size_t row = (size_t)(row0 + ai * HALF + m * 16);
#pragma unroll
                for (int bj = 0; bj < 2; ++bj) { const f32x4 b0 = *(const f32x4*)(bias + col0 + bj * HALF), b1 = *(const f32x4*)(bias + col0 + bj * HALF + 4);
                    const u32x4 z = *(const u32x4*)(Zb + row * 256 + col0 + bj * HALF);
                    const f32x4 v0 = acc[ai][bj][m][0] + b0, v1 = acc[ai][bj][m][1] + b1;
                    u32x4 w; w.x = cvt_pk_bf16(bflo(z.x) * sigmoidf_(v0[0]), bfhi(z.x) * sigmoidf_(v0[1])); w.y = cvt_pk_bf16(bflo(z.y) * sigmoidf_(v0[2]), bfhi(z.y) * sigmoidf_(v0[3]));
                    w.z = cvt_pk_bf16(bflo(z.z) * sigmoidf_(v1[0]), bfhi(z.z) * sigmoidf_(v1[1])); w.w = cvt_pk_bf16(bflo(z.w) * sigmoidf_(v1[2]), bfhi(z.w) * sigmoidf_(v1[3]));
                    *(u32x4*)(MIX + row * D + 768 + col0 + bj * HALF) = w; }
                asm volatile("" ::: "memory"); }
    }
};
}

struct Params { const float* in[27]; float* out; unsigned char* ws; };
enum { I_X = 0, I_C, I_CTX, I_CCTX, I_WADA, I_BADA, I_NORMG, I_WIN, I_WOUT, I_LAM, I_SUBLN, I_HGLB, I_HGNORM, I_SCW, I_SCB, I_AR, I_AI, I_LOGDT, I_BR, I_BI, I_CR, I_CI, I_S5D, I_WGLU, I_BGLU, I_WF1, I_WF2 };

__device__ __forceinline__ void transpose_item(const float* W, int K, int N, bf16_t* WT, int kb, int n0, int drow0, LAS float* scr, int lane) {
    const int k0 = 64 * kb;
#pragma unroll 8
    for (int i = 0; i < 32; ++i) { const int kk = 2 * i + (lane >> 5); scr[kk * 33 + (lane & 31)] = W[(size_t)(k0 + kk) * N + n0 + (lane & 31)]; }
    asm volatile("s_waitcnt lgkmcnt(0)" ::: "memory");
    const int c = lane & 7;
#pragma unroll
    for (int j = 0; j < 4; ++j) { const int n = (lane >> 3) + 8 * j; const LAS float* s = scr + (8 * c) * 33 + n;
        u32x4 o; o.x = cvt_pk_bf16(s[0 * 33], s[1 * 33]); o.y = cvt_pk_bf16(s[2 * 33], s[3 * 33]); o.z = cvt_pk_bf16(s[4 * 33], s[5 * 33]); o.w = cvt_pk_bf16(s[6 * 33], s[7 * 33]);
        *(u32x4*)(WT + (size_t)(drow0 + n) * K + k0 + 8 * c) = o; }
    asm volatile("s_waitcnt lgkmcnt(0)" ::: "memory");
}

__device__ __forceinline__ void row_pass(int gw, int ngw, int lane, int nrows, const bf16_t* RAW, const float* xsrc, const float* csrc, float* xdst, float* cdst,
                                         const float* modl, int gate_chunk, const float* gu, bool donorm, const float* modn, int sh_chunk, const float* gn, bf16_t* XN) {
    for (int row = gw; row < nrows; row += ngw) {
        const bool isx = row < MX; const int mi = isx ? (row >> 11) : 32;
        const float* src = isx ? xsrc + (size_t)row * D : csrc + (size_t)(row - MX) * D;
        f32x4 v[4];
#pragma unroll
        for (int j = 0; j < 4; ++j) v[j] = *(const f32x4*)(src + 4 * lane + 256 * j);
        if (RAW) {
            float* dst = isx ? xdst + (size_t)row * D : cdst + (size_t)(row - MX) * D;
            f32x4 r[4]; float ss = 0.f;
#pragma unroll
            for (int j = 0; j < 4; ++j) { const u32x2 w = *(const u32x2*)(RAW + (size_t)row * D + 4 * lane + 256 * j); r[j] = (f32x4){bflo(w.x), bfhi(w.x), bflo(w.y), bfhi(w.y)};
                ss += (r[j][0] * r[j][0] + r[j][1] * r[j][1]) + (r[j][2] * r[j][2] + r[j][3] * r[j][3]); }
            const float rs = rsqrtf(wave_sum(ss) * (1.f / D) + EPS);
#pragma unroll
            for (int j = 0; j < 4; ++j) { const f32x4 gt = *(const f32x4*)(modl + (size_t)mi * 6144 + gate_chunk * 1024 + 4 * lane + 256 * j); const f32x4 g4 = *(const f32x4*)(gu + 4 * lane + 256 * j);
                v[j] = v[j] + gt * (r[j] * rs * g4); *(f32x4*)(dst + 4 * lane + 256 * j) = v[j]; }
        }
        if (donorm) {
            float ss = 0.f;
#pragma unroll
            for (int j = 0; j < 4; ++j) ss += (v[j][0] * v[j][0] + v[j][1] * v[j][1]) + (v[j][2] * v[j][2] + v[j][3] * v[j][3]);
            const float rs = rsqrtf(wave_sum(ss) * (1.f / D) + EPS);
#pragma unroll
            for (int j = 0; j < 4; ++j) { const float* mb = modn + (size_t)mi * 6144 + sh_chunk * 1024 + 4 * lane + 256 * j;
                const f32x4 sh = *(const f32x4*)mb, sc = *(const f32x4*)(mb + 1024), g4 = *(const f32x4*)(gn + 4 * lane + 256 * j);
                const f32x4 o = (v[j] * rs * g4) * (sc + 1.f) + sh;
                u32x2 w; w.x = cvt_pk_bf16(o[0], o[1]); w.y = cvt_pk_bf16(o[2], o[3]);
                *(u32x2*)(XN + (size_t)row * D + 4 * lane + 256 * j) = w; }
        }
    }
}

__device__ __forceinline__ int seq_row(int b, int p  ) { return p < SEQ ? b * SEQ + p : MX + b * CTX + (p - SEQ); }
__device__ __forceinline__ void attn_unit(const bf16_t* __restrict__ P, bf16_t* __restrict__ MIX, int qrow0, int b, int h, int tb, int te,
                                          float lam, float oscale, const float* __restrict__ subg, LAS unsigned char* sm) {
    int tid = threadIdx.x; asm volatile("" : "+v"(tid));
    const int lane = tid & 63, wid = tid >> 6, r32 = lane & 31, hi = lane >> 5;
    LAS unsigned char* Ks = sm; LAS unsigned char* Vs = sm + 18432;
    LAS float* wsf = (LAS float*)(sm + 35840) + wid * 128;
    LAS float* Ost = (LAS float*)(sm + 39936) + wid * (32 * 68);
    bf16x8 qr[2][2];
    { const bf16_t* qp = P + (size_t)(qrow0 + wid * 32 + r32) * INC + h * 64 + hi * 8;
#pragma unroll
      for (int m = 0; m < 2; ++m)
#pragma unroll
          for (int d0 = 0; d0 < 2; ++d0) qr[m][d0] = *(const bf16x8*)(qp + m * 32 + d0 * 16); }
    const int skey = tid >> 3, sch = tid & 7;
    f32x16 o[2][2];
#pragma unroll
    for (int m = 0; m < 2; ++m)
#pragma unroll
        for (int d0 = 0; d0 < 2; ++d0)
#pragma unroll
            for (int r = 0; r < 16; ++r) o[m][d0][r] = 0.f;
    float mref[2] = {-INFINITY, -INFINITY}, lsum[2] = {0.f, 0.f};
    u32x4 kreg, vreg;
    { const size_t off = (size_t)(seq_row(b, tb * 64) + skey) * INC + h * 64 + sch * 8; kreg = *(const u32x4*)(P + off + 256); vreg = *(const u32x4*)(P + off + 512); }
#define ATT_STAGE(slot) do { *(LAS u32x4*)(Ks + (slot) * 9216 + skey * 144 + sch * 16) = kreg; \
        LAS unsigned char* vb_ = Vs + (slot) * 8704 + (sch * 8) * 136 + skey * 2; \
        *(LAS bf16_t*)(vb_ + 0 * 136) = (bf16_t)(vreg.x & 0xffffu); *(LAS bf16_t*)(vb_ + 1 * 136) = (bf16_t)(vreg.x >> 16); \
        *(LAS bf16_t*)(vb_ + 2 * 136) = (bf16_t)(vreg.y & 0xffffu); *(LAS bf16_t*)(vb_ + 3 * 136) = (bf16_t)(vreg.y >> 16); \
        *(LAS bf16_t*)(vb_ + 4 * 136) = (bf16_t)(vreg.z & 0xffffu); *(LAS bf16_t*)(vb_ + 5 * 136) = (bf16_t)(vreg.z >> 16); \
        *(LAS bf16_t*)(vb_ + 6 * 136) = (bf16_t)(vreg.w & 0xffffu); *(LAS bf16_t*)(vb_ + 7 * 136) = (bf16_t)(vreg.w >> 16); } while (0)
    ATT_STAGE(0);
    __syncthreads();
    for (int t = tb; t < te; ++t) {
        const int cur = (t - tb) & 1; const bool more = (t + 1 < te);
        if (more) { const size_t off = (size_t)(seq_row(b, (t + 1) * 64) + skey) * INC + h * 64 + sch * 8; kreg = *(const u32x4*)(P + off + 256); vreg = *(const u32x4*)(P + off + 512); }
        const LAS unsigned char* Kc = Ks + cur * 9216; const LAS unsigned char* Vc = Vs + cur * 8704;
        bf16x8 pa[2][4];
#pragma unroll
        for (int m = 0; m < 2; ++m) {
            f32x16 p0, p1;
#pragma unroll
            for (int r = 0; r < 16; ++r) { p0[r] = 0.f; p1[r] = 0.f; }
#pragma unroll
            for (int d0 = 0; d0 < 2; ++d0) {
                const bf16x8 k0 = *(const LAS bf16x8*)(Kc + r32 * 144 + (m * 32 + d0 * 16 + hi * 8) * 2);
                const bf16x8 k1 = *(const LAS bf16x8*)(Kc + (32 + r32) * 144 + (m * 32 + d0 * 16 + hi * 8) * 2);
                p0 = __builtin_amdgcn_mfma_f32_32x32x16_bf16(k0, qr[m][d0], p0, 0, 0, 0);
                p1 = __builtin_amdgcn_mfma_f32_32x32x16_bf16(k1, qr[m][d0], p1, 0, 0, 0);
            }
            float rm = fmaxf(p0[0], p1[0]);
#pragma unroll
            for (int r = 1; r < 16; ++r) rm = fmaxf(rm, fmaxf(p0[r], p1[r]));
            rm = fmaxf(rm, __shfl_xor(rm, 32));
            if (__any(rm > mref[m] + 8.f)) {
                const float mnew = fmaxf(mref[m], rm), alpha = fexp2(mref[m] - mnew);
                lsum[m] *= alpha; mref[m] = mnew;
                if (hi == 0) wsf[r32] = alpha;
                asm volatile("s_waitcnt lgkmcnt(0)" ::: "memory");
#pragma unroll
                for (int r4 = 0; r4 < 4; ++r4) { const f32x4 a4 = *(const LAS f32x4*)(wsf + 8 * r4 + 4 * hi);
#pragma unroll
                    for (int j = 0; j < 4; ++j) { o[m][0][4 * r4 + j] *= a4[j]; o[m][1][4 * r4 + j] *= a4[j]; } }
                asm volatile("s_waitcnt lgkmcnt(0)" ::: "memory");
            }
            const float mr = mref[m]; float ls = 0.f;
#pragma unroll
            for (int r = 0; r < 16; ++r) { p0[r] = fexp2(p0[r] - mr); p1[r] = fexp2(p1[r] - mr); ls += p0[r] + p1[r]; }
            lsum[m] += ls;
            pa[m][0] = pack8(p0[0], p0[1], p0[2], p0[3], p0[4], p0[5], p0[6], p0[7]);
            pa[m][1] = pack8(p0[8], p0[9], p0[10], p0[11], p0[12], p0[13], p0[14], p0[15]);
            pa[m][2] = pack8(p1[0], p1[1], p1[2], p1[3], p1[4], p1[5], p1[6], p1[7]);
            pa[m][3] = pack8(p1[8], p1[9], p1[10], p1[11], p1[12], p1[13], p1[14], p1[15]);
        }
#pragma unroll
        for (int d0 = 0; d0 < 2; ++d0)
#pragma unroll
            for (int ks = 0; ks < 4; ++ks) {
                const int kb0 = (ks >> 1) * 32 + (ks & 1) * 16;
                const s16x4 lo = *(const LAS s16x4*)(Vc + (d0 * 32 + r32) * 136 + (kb0 + 4 * hi) * 2);
                const s16x4 hh = *(const LAS s16x4*)(Vc + (d0 * 32 + r32) * 136 + (kb0 + 8 + 4 * hi) * 2);
                const bf16x8 vf = (bf16x8){lo[0], lo[1], lo[2], lo[3], hh[0], hh[1], hh[2], hh[3]};
                o[0][d0] = __builtin_amdgcn_mfma_f32_32x32x16_bf16(pa[0][ks], vf, o[0][d0], 0, 0, 0);
                o[1][d0] = __builtin_amdgcn_mfma_f32_32x32x16_bf16(pa[1][ks], vf, o[1][d0], 0, 0, 0);
            }
        if (more) ATT_STAGE(cur ^ 1);
        __syncthreads();
    }
#undef ATT_STAGE
    const float l0 = lsum[0] + __shfl_xor(lsum[0], 32), l1 = lsum[1] + __shfl_xor(lsum[1], 32);
    if (hi == 0) { wsf[r32] = frcp(l0); wsf[32 + r32] = lam * frcp(l1); }
    asm volatile("s_waitcnt lgkmcnt(0)" ::: "memory");
#pragma unroll
    for (int r = 0; r < 16; ++r) { const int q = crow(r, hi); const float i0 = wsf[q], i1 = wsf[32 + q];
#pragma unroll
        for (int d0 = 0; d0 < 2; ++d0) Ost[q * 68 + d0 * 32 + r32] = o[0][d0][r] * i0 - o[1][d0][r] * i1; }
    asm volatile("s_waitcnt lgkmcnt(0)" ::: "memory");
    { const int q = lane >> 1, half = lane & 1; f32x4 v[8]; float ss = 0.f;
#pragma unroll
      for (int j = 0; j < 8; ++j) { v[j] = *(const LAS f32x4*)(Ost + q * 68 + half * 32 + 4 * j); ss += (v[j][0] * v[j][0] + v[j][1] * v[j][1]) + (v[j][2] * v[j][2] + v[j][3] * v[j][3]); }
      ss += __shfl_xor(ss, 1);
      const float rs = rsqrtf(ss * (1.f / 64.f) + EPS) * oscale;
      bf16_t* op = MIX + (size_t)(qrow0 + wid * 32 + q) * D + h * 64 + half * 32;
#pragma unroll
      for (int j = 0; j < 4; ++j) { const f32x4 g0 = *(const f32x4*)(subg + half * 32 + 8 * j), g1 = *(const f32x4*)(subg + half * 32 + 8 * j + 4); const f32x4 a = v[2 * j] * rs * g0, c = v[2 * j + 1] * rs * g1;
          u32x4 w; w.x = cvt_pk_bf16(a[0], a[1]); w.y = cvt_pk_bf16(a[2], a[3]); w.z = cvt_pk_bf16(c[0], c[1]); w.w = cvt_pk_bf16(c[2], c[3]); *(u32x4*)(op + 8 * j) = w; } }
    asm volatile("s_waitcnt lgkmcnt(0)" ::: "memory");
}

__device__ __forceinline__ int scan_row(int b, int dirn, int p) {
    if (p < CTX) return MX + b * CTX + (dirn ? CTX - 1 - p : p);
    const int t = p - CTX; return b * SEQ + (dirn ? SEQ - 1 - t : t);
}

__device__ __forceinline__ void hgrn_unit(const bf16_t* __restrict__ P, float* OF, float* OB, bf16_t* __restrict__ MIX, int b, int h,
                                          const float* __restrict__ lbv, const float* __restrict__ hnorm, bool ctx_out, LAS unsigned char* sm) {
    int tid = threadIdx.x; asm volatile("" : "+v"(tid));
    const int dirn = tid >> 8, tl = tid & 255, wq = tl >> 6, lane = tid & 63, l16 = lane & 15, quad = lane >> 4;
    LAS unsigned char* base = sm + dirn * 40960;
    const int k = tl & 63, c = tl >> 6;
    const float lb = lbv[dirn * 256 + h * 64 + k], omlb = 1.f - lb;
    float* O = dirn ? OB : OF;
    f32x4 S[4];
#pragma unroll
    for (int i = 0; i < 4; ++i) S[i] = (f32x4){0.f, 0.f, 0.f, 0.f};
    for (int sc = 0; sc < 36; ++sc) {
        const int p0 = sc * 64;
        {
            const int r0 = scan_row(b, dirn, p0 + 16 * c), sgn = dirn ? -1 : 1;
            bf16_t qv[16], fv[16], iv[16];
#pragma unroll
            for (int i = 0; i < 16; ++i) { const bf16_t* pp = P + (size_t)(r0 + sgn * i) * INC + h * 64 + k; qv[i] = pp[768]; fv[i] = pp[(4 + dirn) * 256]; iv[i] = pp[1536]; }
            float G[16], kk[16]; float g = 0.f;
#pragma unroll
            for (int i = 0; i < 16; ++i) { const float fr = bf2f(fv[i]); const float e = fexp(-fr); const float sg = frcp(1.f + e); const float f = lb + omlb * sg;
                kk[i] = omlb * e * sg; g += __logf(f); G[i] = g; }
            const float dec = fexp(g);
            LAS unsigned char* cb = base + c * 10240;
            unsigned kew[8], vtw[8];
#pragma unroll
            for (int i = 0; i < 16; i += 2) {
                float qd[2], ki[2], ke[2];
#pragma unroll
                for (int j = 0; j < 2; ++j) { const float eg = fexp(G[i + j]), ei = frcp(eg); qd[j] = siluf_(bf2f(qv[i + j])) * eg; ki[j] = kk[i + j] * ei; ke[j] = ki[j] * dec; }
                *(LAS bf16_t*)(cb + i * 144 + k * 2) = f2bf(qd[0]); *(LAS bf16_t*)(cb + (i + 1) * 144 + k * 2) = f2bf(qd[1]);
                *(LAS bf16_t*)(cb + 2304 + i * 144 + k * 2) = f2bf(ki[0]); *(LAS bf16_t*)(cb + 2304 + (i + 1) * 144 + k * 2) = f2bf(ki[1]);
                kew[i >> 1] = cvt_pk_bf16(ke[0], ke[1]); vtw[i >> 1] = (unsigned)iv[i] | ((unsigned)iv[i + 1] << 16);
            }
#pragma unroll
            for (int j = 0; j < 4; ++j) { *(LAS u32x2*)(cb + 4608 + k * 40 + j * 8) = (u32x2){kew[2 * j], kew[2 * j + 1]}; *(LAS u32x2*)(cb + 7168 + k * 40 + j * 8) = (u32x2){vtw[2 * j], vtw[2 * j + 1]}; }
            *(LAS float*)(cb + 9728 + k * 4) = dec;
        }
        __syncthreads();
#pragma unroll 1
        for (int cc = 0; cc < 4; ++cc) {
            const LAS unsigned char* cb = base + cc * 10240;
            f32x4 at = (f32x4){0.f, 0.f, 0.f, 0.f};
#pragma unroll
            for (int kh = 0; kh < 2; ++kh) { const bf16x8 ki = *(const LAS bf16x8*)(cb + 2304 + l16 * 144 + (kh * 32 + quad * 8) * 2); const bf16x8 qd = *(const LAS bf16x8*)(cb + l16 * 144 + (kh * 32 + quad * 8) * 2);
                at = __builtin_amdgcn_mfma_f32_16x16x32_bf16(ki, qd, at, 0, 0, 0); }
#pragma unroll
            for (int jj = 0; jj < 4; ++jj) if (4 * quad + jj > l16) at[jj] = 0.f;
            const s16x4 atb = pack4(at);
            const s16x4 vt = *(const LAS s16x4*)(cb + 7168 + (wq * 16 + l16) * 40 + quad * 8);
            f32x4 ot = __builtin_amdgcn_mfma_f32_16x16x16bf16_1k(vt, atb, (f32x4){0.f, 0.f, 0.f, 0.f}, 0, 0, 0);
#pragma unroll
            for (int kt = 0; kt < 4; ++kt) { const s16x4 sb = pack4(S[kt]); const s16x4 qd4 = *(const LAS s16x4*)(cb + l16 * 144 + (kt * 16 + quad * 4) * 2);
                ot = __builtin_amdgcn_mfma_f32_16x16x16bf16_1k(sb, qd4, ot, 0, 0, 0); }
            { const int row = scan_row(b, dirn, p0 + 16 * cc + l16); *(f32x4*)(O + (size_t)row * 256 + h * 64 + wq * 16 + 4 * quad) = ot; }
#pragma unroll
            for (int kt = 0; kt < 4; ++kt) { const f32x4 dc = *(const LAS f32x4*)(cb + 9728 + (kt * 16 + quad * 4) * 4); const s16x4 ke = *(const LAS s16x4*)(cb + 4608 + (kt * 16 + l16) * 40 + quad * 8);
                S[kt] = __builtin_amdgcn_mfma_f32_16x16x16bf16_1k(ke, vt, S[kt] * dc, 0, 0, 0); }
        }
        __syncthreads();
    }
    __threadfence();
    __syncthreads();
    const int nrows = SEQ + (ctx_out ? CTX : 0);
    for (int idx = tid; idx < nrows * 4; idx += 512) {
        const int rr = idx >> 2, qd = idx & 3; const int row = seq_row(b, rr); const int ch = h * 64 + qd * 16;
        f32x4 v[4]; float ss = 0.f;
#pragma unroll
        for (int j = 0; j < 4; ++j) { v[j] = *(const f32x4*)(OF + (size_t)row * 256 + ch + 4 * j) + *(const f32x4*)(OB + (size_t)row * 256 + ch + 4 * j);
            ss += (v[j][0] * v[j][0] + v[j][1] * v[j][1]) + (v[j][2] * v[j][2] + v[j][3] * v[j][3]); }
        ss += __shfl_xor(ss, 1); ss += __shfl_xor(ss, 2);
        const float rs = rsqrtf(ss * (1.f / 64.f) + EPS);
        const u32x4 g0 = *(const u32x4*)(P + (size_t)row * INC + 7 * 256 + ch), g1 = *(const u32x4*)(P + (size_t)row * INC + 7 * 256 + ch + 8);
        const float gg[16] = {bflo(g0.x), bfhi(g0.x), bflo(g0.y), bfhi(g0.y), bflo(g0.z), bfhi(g0.z), bflo(g0.w), bfhi(g0.w), bflo(g1.x), bfhi(g1.x), bflo(g1.y), bfhi(g1.y), bflo(g1.z), bfhi(g1.z), bflo(g1.w), bfhi(g1.w)};
        float ov[16];
#pragma unroll
        for (int j = 0; j < 4; ++j) { const f32x4 n4 = *(const f32x4*)(hnorm + qd * 16 + 4 * j);
#pragma unroll
            for (int e = 0; e < 4; ++e) ov[4 * j + e] = v[j][e] * rs * n4[e] * siluf_(gg[4 * j + e]); }
        u32x4 w0, w1; w0.x = cvt_pk_bf16(ov[0], ov[1]); w0.y = cvt_pk_bf16(ov[2], ov[3]); w0.z = cvt_pk_bf16(ov[4], ov[5]); w0.w = cvt_pk_bf16(ov[6], ov[7]);
        w1.x = cvt_pk_bf16(ov[8], ov[9]); w1.y = cvt_pk_bf16(ov[10], ov[11]); w1.z = cvt_pk_bf16(ov[12], ov[13]); w1.w = cvt_pk_bf16(ov[14], ov[15]);
        bf16_t* op = MIX + (size_t)row * D + 256 + ch; *(u32x4*)op = w0; *(u32x4*)(op + 8) = w1;
    }
    __syncthreads();
}

__device__ __forceinline__ void s5_unit(const bf16_t* __restrict__ P, float* YF, float* YB, bf16_t* __restrict__ Z, int b, int gq,
                                        const float* __restrict__ s5p, const float* __restrict__ cre, const float* __restrict__ cim, const float* __restrict__ dvec,
                                        bool ctx_out, LAS unsigned char* sm) {
    int tid = threadIdx.x; asm volatile("" : "+v"(tid));
    const int wid = tid >> 6, lane = tid & 63, dirn = wid >> 2, g = gq * 4 + (wid & 3);
    const int r32 = lane & 31, hi = lane >> 5, l16 = lane & 15, quad = lane >> 4;
    LAS unsigned char* XL = sm + wid * 8704;
    const float* sp = s5p + (size_t)(dirn * 16 + g) * 2176;
    float ar[2][4], ai[2][4];
#pragma unroll
    for (int s = 0; s < 2; ++s) { const int n = 32 * s + r32; ar[s][0] = sp[n]; ai[s][0] = sp[64 + n];
#pragma unroll
        for (int j = 1; j < 4; ++j) { ar[s][j] = ar[s][j - 1] * ar[s][0] - ai[s][j - 1] * ai[s][0]; ai[s][j] = ar[s][j - 1] * ai[s][0] + ai[s][j - 1] * ar[s][0]; } }
    bf16x8 bfrag[4], cfrag[4];
#pragma unroll
    for (int nt = 0; nt < 4; ++nt) { const int n = (nt >> 1) * 32 + r32; const float* src = sp + 128 + (nt & 1) * 1024 + n * 16 + hi * 8;
        const f32x4 a = *(const f32x4*)src, c = *(const f32x4*)(src + 4); bfrag[nt] = pack8(a[0], a[1], a[2], a[3], c[0], c[1], c[2], c[3]); }
#pragma unroll
    for (int kb = 0; kb < 4; ++kb) { const int n0 = (kb >> 1) * 32 + quad * 8; const float* src = ((kb & 1) ? cim : cre) + (size_t)((dirn * 16 + g) * 16 + l16) * 64 + n0;
        const float sg = (kb & 1) ? -1.f : 1.f; const f32x4 a = *(const f32x4*)src * sg, c = *(const f32x4*)(src + 4) * sg; cfrag[kb] = pack8(a[0], a[1], a[2], a[3], c[0], c[1], c[2], c[3]); }
    float* Y = dirn ? YB : YF;
    float xr[2] = {0.f, 0.f}, xi[2] = {0.f, 0.f};
    const size_t ucol = (size_t)11 * 256 + g * 16 + hi * 8;
    bf16x8 unext = *(const bf16x8*)(P + (size_t)scan_row(b, dirn, r32) * INC + ucol);
#pragma unroll 1
    for (int ch = 0; ch < 72; ++ch) {
        const int p0 = ch * 32;
        const bf16x8 uf = unext;
        if (ch + 1 < 72) unext = *(const bf16x8*)(P + (size_t)scan_row(b, dirn, p0 + 32 + r32) * INC + ucol);
#pragma unroll
        for (int s = 0; s < 2; ++s) {
            f32x16 R, I;
#pragma unroll
            for (int r = 0; r < 16; ++r) { R[r] = 0.f; I[r] = 0.f; }
            R = __builtin_amdgcn_mfma_f32_32x32x16_bf16(uf, bfrag[2 * s], R, 0, 0, 0);
            I = __builtin_amdgcn_mfma_f32_32x32x16_bf16(uf, bfrag[2 * s + 1], I, 0, 0, 0);
            const float a1r = ar[s][0], a1i = ai[s][0], a4r = ar[s][3], a4i = ai[s][3];
#pragma unroll
            for (int a = 0; a < 4; ++a)
#pragma unroll
                for (int j = 1; j < 4; ++j) { const float pr = R[4 * a + j - 1], pi = I[4 * a + j - 1]; R[4 * a + j] += a1r * pr - a1i * pi; I[4 * a + j] += a1r * pi + a1i * pr; }
            float cr_ = xr[s], ci_ = xi[s], gr[4], gi[4];
#pragma unroll
            for (int a = 0; a < 4; ++a) {
                const float e0r = a4r * cr_ - a4i * ci_ + R[4 * a + 3], e0i = a4r * ci_ + a4i * cr_ + I[4 * a + 3];
                const float in1r = __shfl_xor(e0r, 32), in1i = __shfl_xor(e0i, 32);
                const float e1r = a4r * in1r - a4i * in1i + R[4 * a + 3], e1i = a4r * in1i + a4i * in1r + I[4 * a + 3];
                const float p1r = __shfl_xor(e1r, 32), p1i = __shfl_xor(e1i, 32);
                gr[a] = hi ? in1r : cr_; gi[a] = hi ? in1i : ci_;
                cr_ = hi ? e1r : p1r; ci_ = hi ? e1i : p1i;
            }
            xr[s] = cr_; xi[s] = ci_;
#pragma unroll
            for (int a = 0; a < 4; ++a)
#pragma unroll
                for (int j = 0; j < 4; ++j) { R[4 * a + j] += ar[s][j] * gr[a] - ai[s][j] * gi[a]; I[4 * a + j] += ar[s][j] * gi[a] + ai[s][j] * gr[a]; }
#pragma unroll
            for (int r = 0; r < 16; ++r) { LAS unsigned char* xp = XL + crow(r, hi) * 272 + (64 * s + r32) * 2; *(LAS bf16_t*)xp = f2bf(R[r]); *(LAS bf16_t*)(xp + 64) = f2bf(I[r]); }
        }
        asm volatile("s_waitcnt lgkmcnt(0)" ::: "memory");
#pragma unroll
        for (int mt = 0; mt < 2; ++mt) {
            f32x4 y = (f32x4){0.f, 0.f, 0.f, 0.f};
#pragma unroll
            for (int kb = 0; kb < 4; ++kb) { const bf16x8 a = *(const LAS bf16x8*)(XL + (16 * mt + l16) * 272 + (32 * kb + 8 * quad) * 2); y = __builtin_amdgcn_mfma_f32_16x16x32_bf16(a, cfrag[kb], y, 0, 0, 0); }
#pragma unroll
            for (int jj = 0; jj < 4; ++jj) { const int row = scan_row(b, dirn, p0 + 16 * mt + 4 * quad + jj); Y[(size_t)row * 256 + g * 16 + l16] = y[jj]; }
        }
        asm volatile("s_waitcnt lgkmcnt(0)" ::: "memory");
    }
    __threadfence();
    __syncthreads();
    const int nrows = SEQ + (ctx_out ? CTX : 0);
    for (int idx = tid; idx < nrows * 4; idx += 512) {
        const int rr = idx >> 2, qd = idx & 3; const int row = seq_row(b, rr); const int ch = gq * 64 + qd * 16;
        const u32x4 u0 = *(const u32x4*)(P + (size_t)row * INC + 11 * 256 + ch), u1 = *(const u32x4*)(P + (size_t)row * INC + 11 * 256 + ch + 8);
        const float uu[16] = {bflo(u0.x), bfhi(u0.x), bflo(u0.y), bfhi(u0.y), bflo(u0.z), bfhi(u0.z), bflo(u0.w), bfhi(u0.w), bflo(u1.x), bfhi(u1.x), bflo(u1.y), bfhi(u1.y), bflo(u1.z), bfhi(u1.z), bflo(u1.w), bfhi(u1.w)};
        float zv[16];
#pragma unroll
        for (int j = 0; j < 4; ++j) { const f32x4 yy = *(const f32x4*)(YF + (size_t)row * 256 + ch + 4 * j) + *(const f32x4*)(YB + (size_t)row * 256 + ch + 4 * j); const f32x4 d4 = *(const f32x4*)(dvec + ch + 4 * j);
#pragma unroll
            for (int e = 0; e < 4; ++e) { const float y = yy[e] + d4[e] * uu[4 * j + e]; const float a = 0.7978845608028654f * (y + 0.044715f * y * y * y);
                const float th = 1.f - 2.f * frcp(fexp(2.f * a) + 1.f); zv[4 * j + e] = 0.5f * y * (1.f + th); } }
        u32x4 w0, w1; w0.x = cvt_pk_bf16(zv[0], zv[1]); w0.y = cvt_pk_bf16(zv[2], zv[3]); w0.z = cvt_pk_bf16(zv[4], zv[5]); w0.w = cvt_pk_bf16(zv[6], zv[7]);
        w1.x = cvt_pk_bf16(zv[8], zv[9]); w1.y = cvt_pk_bf16(zv[10], zv[11]); w1.z = cvt_pk_bf16(zv[12], zv[13]); w1.w = cvt_pk_bf16(zv[14], zv[15]);
        bf16_t* op = Z + (size_t)row * 256 + ch; *(u32x4*)op = w0; *(u32x4*)(op + 8) = w1;
    }
    __syncthreads();
}

__device__ __forceinline__ void conv_unit(const bf16_t* __restrict__ P, bf16_t* __restrict__ MIX, int tile, const float* __restrict__ scw, const float* __restrict__ scb) {
    int tid = threadIdx.x; asm volatile("" : "+v"(tid));
    for (int idx = tid; idx < 256 * 32; idx += 512) {
        const int row = tile * 256 + (idx >> 5), c8 = (idx & 31) * 8;
        const bool isx = row < MX; const int t = isx ? (row & (SEQ - 1)) : ((row - MX) & (CTX - 1)); const int len = isx ? SEQ : CTX;
        const bf16_t* pr = P + (size_t)row * INC + c8;
        const u32x4 bg = *(const u32x4*)(pr + 8 * 256);
        float vm[3][8];
#pragma unroll
        for (int d = 0; d < 3; ++d) { const int tt = t + d - 1;
            if (tt >= 0 && tt < len) { const u32x4 cg_ = *(const u32x4*)(pr + (ptrdiff_t)(d - 1) * INC + 9 * 256), ug = *(const u32x4*)(pr + (ptrdiff_t)(d - 1) * INC + 10 * 256);
                vm[d][0] = bflo(cg_.x) * bflo(ug.x); vm[d][1] = bfhi(cg_.x) * bfhi(ug.x); vm[d][2] = bflo(cg_.y) * bflo(ug.y); vm[d][3] = bfhi(cg_.y) * bfhi(ug.y);
                vm[d][4] = bflo(cg_.z) * bflo(ug.z); vm[d][5] = bfhi(cg_.z) * bfhi(ug.z); vm[d][6] = bflo(cg_.w) * bflo(ug.w); vm[d][7] = bfhi(cg_.w) * bfhi(ug.w); }
            else {
#pragma unroll
                for (int e = 0; e < 8; ++e) vm[d][e] = 0.f; } }
        const float bgf[8] = {bflo(bg.x), bfhi(bg.x), bflo(bg.y), bfhi(bg.y), bflo(bg.z), bfhi(bg.z), bflo(bg.w), bfhi(bg.w)};
        float ov[8];
#pragma unroll
        for (int e = 0; e < 8; ++e) ov[e] = bgf[e] * (scw[c8 + e] * vm[0][e] + scw[256 + c8 + e] * vm[1][e] + scw[512 + c8 + e] * vm[2][e] + scb[c8 + e]);
        u32x4 w; w.x = cvt_pk_bf16(ov[0], ov[1]); w.y = cvt_pk_bf16(ov[2], ov[3]); w.z = cvt_pk_bf16(ov[4], ov[5]); w.w = cvt_pk_bf16(ov[6], ov[7]);
        *(u32x4*)(MIX + (size_t)row * D + 512 + c8) = w;
    }
}

typedef const Params __attribute__((address_space(4))) * kparams_t;
#define KP() ({ kparams_t _p = (kparams_t)__builtin_amdgcn_kernarg_segment_ptr(); asm volatile("" : "+s"(_p)); _p; })
#define WSP(T, off) ((T*)(kp->ws + (off)))
__global__ void __launch_bounds__(512, 2) fwd_megakernel(Params prm_unused) {
    extern __shared__ __attribute__((aligned(16))) unsigned char lds_raw[];
    LAS unsigned char* lds = (LAS unsigned char*)lds_raw;
    cg::grid_group grid = cg::this_grid();

        asm volatile("; MARK_P0a");
    {
        kparams_t kp = KP();
        const int tid = threadIdx.x, lane = tid & 63, wave = tid >> 6, G = gridDim.x; const int gw = blockIdx.x * 8 + wave, ngw = G * 8;
        LAS float* scr = (LAS float*)(lds + wave * 16384);
        constexpr int I_IN = 16 * 96, I_OUT = 16 * 32, I_F1 = 16 * 176, I_F2 = 44 * 32, I_GL = 4 * 8, I_PER = I_IN + I_OUT + I_F1 + I_F2 + I_GL;
        for (int it = gw; it < 2 * I_PER; it += ngw) {
            const int l = it / I_PER; int r = it % I_PER;
            if (r < I_IN) { const int kb = r / 96, nb = r % 96; transpose_item(kp->in[I_WIN] + (size_t)l * D * INC, D, INC, WSP(bf16_t, WS_WIN) + (size_t)l * INC * D, kb, nb * 32, nb * 32, scr, lane); continue; } r -= I_IN;
            if (r < I_OUT) { const int kb = r / 32, nb = r % 32; transpose_item(kp->in[I_WOUT] + (size_t)l * D * D, D, D, WSP(bf16_t, WS_WOUT) + (size_t)l * D * D, kb, nb * 32, nb * 32, scr, lane); continue; } r -= I_OUT;
            if (r < I_F1) { const int kb = r / 176, nb = r % 176; const int n0 = nb * 32; const int nn = n0 < FH ? n0 : n0 - FH; const int drow = (nn / 128) * 256 + (n0 < FH ? 0 : 128) + (nn % 128);
                transpose_item(kp->in[I_WF1] + (size_t)l * D * 2 * FH, D, 2 * FH, WSP(bf16_t, WS_WF1) + (size_t)l * 2 * FH * D, kb, n0, drow, scr, lane); continue; } r -= I_F1;
            if (r < I_F2) { const int kb = r / 32, nb = r % 32; transpose_item(kp->in[I_WF2] + (size_t)l * FH * D, FH, D, WSP(bf16_t, WS_WF2) + (size_t)l * D * FH, kb, nb * 32, nb * 32, scr, lane); continue; } r -= I_F2;
            { const int kb = r / 8, nb = r % 8; transpose_item(kp->in[I_WGLU] + (size_t)l * 256 * 256, 256, 256, WSP(bf16_t, WS_WGLU) + (size_t)l * 256 * 256, kb, nb * 32, nb * 32, scr, lane); }
        }
    }
    {
        kparams_t kp = KP();
        const int tid = threadIdx.x, lane = tid & 63, wave = tid >> 6, G = gridDim.x; const int gw = blockIdx.x * 8 + wave, ngw = G * 8;
        float* MOD = WSP(float, WS_MOD);
        for (int it = gw; it < 2 * 11 * 96; it += ngw) {
            const int l = it / 1056, rem = it % 1056, rg = rem / 96, cc = rem % 96; const int col = cc * 64 + lane;
            const float* src[3];
#pragma unroll
            for (int j = 0; j < 3; ++j) { const int r = rg * 3 + j; src[j] = r < 32 ? kp->in[I_C] + (size_t)r * D : kp->in[I_CCTX]; }
            const float* W = kp->in[I_WADA] + (size_t)l * D * 6144 + col;
            float a0 = 0.f, a1 = 0.f, a2 = 0.f;
            for (int k0 = 0; k0 < D; k0 += 64) {
                const float s0 = siluf_(src[0][k0 + lane]), s1 = siluf_(src[1][k0 + lane]), s2 = siluf_(src[2][k0 + lane]);
#pragma unroll 16
                for (int kk = 0; kk < 64; ++kk) { const float w = W[(size_t)(k0 + kk) * 6144];
                    a0 += __shfl(s0, kk) * w; a1 += __shfl(s1, kk) * w; a2 += __shfl(s2, kk) * w; }
            }
            const float bb = kp->in[I_BADA][(size_t)l * 6144 + col];
            float* mo = MOD + ((size_t)l * 33 + rg * 3) * 6144 + col; mo[0] = a0 + bb; mo[6144] = a1 + bb; mo[2 * 6144] = a2 + bb;
        }
        const int gt = blockIdx.x * 512 + tid, ngt = G * 512;
        float* ROPEC = WSP(float, WS_ROPE); float* ROPES = ROPEC + SEQ * 16;
        for (int i = gt; i < SEQ * 16; i += ngt) { const int t = i >> 4, j = i & 15; const float pos = (float)(j < 8 ? (t >> 6) : (t & 63));
            const int jj = j & 7;
            const float iv = jj == 0 ? 1.f : jj == 1 ? 0.31622776601683794f : jj == 2 ? 0.1f : jj == 3 ? 0.031622776601683794f : jj == 4 ? 0.01f : jj == 5 ? 0.0031622776601683794f : jj == 6 ? 0.001f : 0.00031622776601683794f;
            const float ang = pos * iv; double s, c; sincos_d((double)ang, s, c); ROPEC[i] = (float)c; ROPES[i] = (float)s; }
        float* S5P = WSP(float, WS_S5P);
        for (int i = gt; i < 2 * 2 * 16 * 64; i += ngt) { const int n = i & 63, lg = i >> 6;
            const double are = kp->in[I_AR][i], aim = kp->in[I_AI][i]; const double dt = exp((double)kp->in[I_LOGDT][lg]);
            const double mag = exp(dt * are); double s, c; sincos_d(dt * aim, s, c); const double abr = mag * c, abi = mag * s;
            const double den = are * are + aim * aim, nr = abr - 1.0; const double fre = (nr * are + abi * aim) / den, fim = (abi * are - nr * aim) / den;
            float* sp = S5P + (size_t)lg * 2176; sp[n] = (float)abr; sp[64 + n] = (float)abi;
            const float* bre = kp->in[I_BR] + (size_t)i * 16; const float* bim = kp->in[I_BI] + (size_t)i * 16;
#pragma unroll
            for (int p = 0; p < 16; ++p) { const double br = bre[p], bi = bim[p]; sp[128 + n * 16 + p] = (float)(fre * br - fim * bi); sp[128 + 1024 + n * 16 + p] = (float)(fre * bi + fim * br); } }
        if (blockIdx.x == 0) {
            float* PRM = WSP(float, WS_PRM);
            if (tid < 2) { const float* lv = kp->in[I_LAM] + tid * 128; float d0 = 0.f, d1 = 0.f; for (int j = 0; j < 32; ++j) { d0 += lv[j] * lv[32 + j]; d1 += lv[64 + j] * lv[96 + j]; }
                const float li = 0.8f - 0.6f * __expf(-0.3f * (float)tid); PRM[tid * 2] = __expf(d0) - __expf(d1) + li; PRM[tid * 2 + 1] = 1.f - li; }
            { const int i = tid; const float h0 = kp->in[I_HGLB][i], h1 = kp->in[I_HGLB][512 + i]; PRM[16 + i] = 0.f; PRM[16 + 512 + i] = 1.f / (1.f + __expf(h0 - h1)); }
        }
    }
    grid.sync();
        asm volatile("; MARK_P0b");
    {
        kparams_t kp = KP();
        const int tid = threadIdx.x, lane = tid & 63, wave = tid >> 6, G = gridDim.x; const int gw = blockIdx.x * 8 + wave, ngw = G * 8;
        row_pass(gw, ngw, lane, MT, nullptr, kp->in[I_X], kp->in[I_CTX], nullptr, nullptr, nullptr, 0, nullptr, true, WSP(float, WS_MOD), 0, kp->in[I_NORMG], WSP(bf16_t, WS_XN));
    }
    grid.sync();

#pragma unroll 1
    for (int l = 0; l < DEPTH; ++l) {
        asm volatile("; MARK_P1");
#ifndef NO_P1
        { kparams_t kp = KP(); const int G = gridDim.x;
          pg8::Gemm g{WSP(bf16_t, WS_XN), WSP(bf16_t, WS_WIN) + (size_t)l * INC * D, MT, INC, D}; pg8::StaticOrder S; S.init(MT, INC, G, (int)blockIdx.x);
          pg8::EpiInProj E{WSP(bf16_t, WS_P), WSP(float, WS_ROPE), WSP(float, WS_ROPE) + SEQ * 16}; pg8::gemm_phase<pg8::EpiInProj>(lds, g, S, E); }
#endif
        grid.sync();
        asm volatile("; MARK_P2");
        {
            kparams_t kp = KP();
            const int tid = threadIdx.x;
            const bool ctx_out = (l < DEPTH - 1);
            const int n_s5 = 128, n_hg = 128, n_ax = 1024, n_ac = ctx_out ? 128 : 0, n_cv = ctx_out ? MT / 256 : MX / 256;
            const int total = n_s5 + n_hg + n_ax + n_ac + n_cv;
            volatile LAS int* sitem = (volatile LAS int*)(lds + MISC_OFF);
            for (;;) {
                if (tid == 0) *sitem = (int)atomicAdd(WSP(unsigned, WS_CTL) + 64 * (l + 1), 1u);
                __syncthreads();
                int it = *sitem;
                __syncthreads();
                if (it >= total) break;
                bf16_t* PB = WSP(bf16_t, WS_P); bf16_t* MIX = WSP(bf16_t, WS_XN); const float* PRM = WSP(float, WS_PRM);
                if (it < n_s5) {
#ifndef NO_S5
                    float* YF = WSP(float, WS_Y);
                    s5_unit(PB, YF, YF + (size_t)MT * 256, WSP(bf16_t, WS_Z), it >> 2, it & 3, WSP(float, WS_S5P) + (size_t)l * 32 * 2176, kp->in[I_CR] + (size_t)l * 32 * 1024, kp->in[I_CI] + (size_t)l * 32 * 1024, kp->in[I_S5D] + l * 256, ctx_out, lds);
#endif
                    continue; } it -= n_s5;
                if (it < n_hg) {
#ifndef NO_HG
                    float* OF = WSP(float, WS_RAW);
                    hgrn_unit(PB, OF, OF + (size_t)MT * 256, MIX, it >> 2, it & 3, PRM + 16 + l * 512, kp->in[I_HGNORM] + l * 64, ctx_out, lds);
#endif
                    continue; } it -= n_hg;
                if (it < n_ax + n_ac) {
#ifndef NO_ATT
                    int b, h, qrow0, tb;
                    if (it < n_ax) { b = it >> 5; h = (it >> 3) & 3; qrow0 = b * SEQ + (it & 7) * 256; tb = 0; } else { const int i2 = it - n_ax; b = i2 >> 2; h = i2 & 3; qrow0 = MX + b * CTX; tb = 32; }
                    attn_unit(PB, MIX, qrow0, b, h, tb, 36, PRM[l * 2], PRM[l * 2 + 1], kp->in[I_SUBLN] + l * 64, lds);
#endif
                    continue; } it -= n_ax + n_ac;
                conv_unit(PB, MIX, it, kp->in[I_SCW] + l * 768, kp->in[I_SCB] + l * 256);
            }
        }
        grid.sync();
        asm volatile("; MARK_P3");
#ifndef NO_P3
        { kparams_t kp = KP(); const int G = gridDim.x; const int Mrows = (l < DEPTH - 1) ? MT : MX;
          pg8::Gemm g{WSP(bf16_t, WS_Z), WSP(bf16_t, WS_WGLU) + (size_t)l * 256 * 256, Mrows, 256, 256}; pg8::StaticOrder S; S.init(Mrows, 256, G, (int)blockIdx.x);
          pg8::EpiGLU E{WSP(bf16_t, WS_XN), WSP(bf16_t, WS_Z), kp->in[I_BGLU] + l * 256}; pg8::gemm_phase<pg8::EpiGLU>(lds, g, S, E); }
#endif
        grid.sync();
        asm volatile("; MARK_P4");
#ifndef NO_P4
        { kparams_t kp = KP(); const int G = gridDim.x; const int Mrows = (l < DEPTH - 1) ? MT : MX;
          pg8::Gemm g{WSP(bf16_t, WS_XN), WSP(bf16_t, WS_WOUT) + (size_t)l * D * D, Mrows, D, D}; pg8::StaticOrder S; S.init(Mrows, D, G, (int)blockIdx.x);
          pg8::EpiPlain E{WSP(bf16_t, WS_RAW), D}; pg8::gemm_phase<pg8::EpiPlain>(lds, g, S, E); }
#endif
        grid.sync();
        asm volatile("; MARK_P5");
        { kparams_t kp = KP(); const int tid = threadIdx.x, lane = tid & 63, wave = tid >> 6, G = gridDim.x; const int gw = blockIdx.x * 8 + wave, ngw = G * 8; const int Mrows = (l < DEPTH - 1) ? MT : MX;
          const float* modl = WSP(float, WS_MOD) + (size_t)l * 33 * 6144; const float* ng = kp->in[I_NORMG] + (size_t)l * 4 * D; float* xout = kp->out; float* HS = WSP(float, WS_HS);
          row_pass(gw, ngw, lane, Mrows, WSP(bf16_t, WS_RAW), l == 0 ? kp->in[I_X] : xout, l == 0 ? kp->in[I_CTX] : HS, xout, HS, modl, 2, ng + D, true, modl, 3, ng + 2 * D, WSP(bf16_t, WS_XN)); }
        grid.sync();
        asm volatile("; MARK_P6");
#ifndef NO_P6
        { kparams_t kp = KP(); const int G = gridDim.x; const int Mrows = (l < DEPTH - 1) ? MT : MX;
          pg8::Gemm g{WSP(bf16_t, WS_XN), WSP(bf16_t, WS_WF1) + (size_t)l * 2 * FH * D, Mrows, 2 * FH, D}; pg8::StaticOrder S; S.init(Mrows, 2 * FH, G, (int)blockIdx.x);
          pg8::EpiSwiGLU E{WSP(bf16_t, WS_P)}; pg8::gemm_phase<pg8::EpiSwiGLU>(lds, g, S, E); }
#endif
        grid.sync();
        asm volatile("; MARK_P7");
#ifndef NO_P7
        { kparams_t kp = KP(); const int G = gridDim.x; const int Mrows = (l < DEPTH - 1) ? MT : MX;
          pg8::Gemm g{WSP(bf16_t, WS_P), WSP(bf16_t, WS_WF2) + (size_t)l * D * FH, Mrows, D, FH}; pg8::StaticOrder S; S.init(Mrows, D, G, (int)blockIdx.x);
          pg8::EpiPlain E{WSP(bf16_t, WS_RAW), D}; pg8::gemm_phase<pg8::EpiPlain>(lds, g, S, E); }
#endif
        grid.sync();
        asm volatile("; MARK_P8");
        { kparams_t kp = KP(); const int tid = threadIdx.x, lane = tid & 63, wave = tid >> 6, G = gridDim.x; const int gw = blockIdx.x * 8 + wave, ngw = G * 8; const bool ctx_out = (l < DEPTH - 1); const int Mrows = ctx_out ? MT : MX;
          const float* modl = WSP(float, WS_MOD) + (size_t)l * 33 * 6144; const float* ng = kp->in[I_NORMG] + (size_t)l * 4 * D; float* xout = kp->out; float* HS = WSP(float, WS_HS);
          row_pass(gw, ngw, lane, Mrows, WSP(bf16_t, WS_RAW), xout, HS, xout, HS, modl, 5, ng + 3 * D, ctx_out, modl + 33 * 6144, 0, ng + 4 * D, WSP(bf16_t, WS_XN)); }
        if (l < DEPTH - 1) grid.sync();
    }
}

extern "C" void kernel_launch(void* const* d_in, const int* in_sizes, int n_in, void* d_out, int out_size, void* d_ws, size_t ws_size, hipStream_t stream) {
    static int grid = 0;
    if (grid == 0) {
        if (n_in != 27 || in_sizes[0] != MX * D || out_size != MX * D || ws_size < WS_END) { fprintf(stderr, "kernel_launch: unexpected shapes (n_in %d, in0 %d, out %d, ws %zu)\n", n_in, n_in > 0 ? in_sizes[0] : -1, out_size, ws_size); grid = -1; return; }
        int dev = 0, cus = 0, per_cu = 0;
        if (hipGetDevice(&dev) != hipSuccess || hipDeviceGetAttribute(&cus, hipDeviceAttributeMultiprocessorCount, dev) != hipSuccess) { grid = -1; return; }
        if (hipFuncSetAttribute((const void*)fwd_megakernel, hipFuncAttributeMaxDynamicSharedMemorySize, LDS_BYTES) != hipSuccess) { fprintf(stderr, "kernel_launch: hipFuncSetAttribute failed\n"); grid = -1; return; }
        if (hipOccupancyMaxActiveBlocksPerMultiprocessor(&per_cu, (const void*)fwd_megakernel, 512, LDS_BYTES) != hipSuccess || per_cu < 1) { fprintf(stderr, "kernel_launch: occupancy query says %d\n", per_cu); per_cu = 1; }
        (void)hipGetLastError();
        grid = cus * per_cu;
    }
    if (grid < 0) return;
    (void)hipMemsetAsync((char*)d_ws + WS_CTL, 0, 4096, stream);
    Params p{};
    for (int i = 0; i < 27; ++i) p.in[i] = (const float*)d_in[i];
    p.out = (float*)d_out; p.ws = (unsigned char*)d_ws;
    void* args[] = {&p};
    const hipError_t e = hipLaunchCooperativeKernel((const void*)fwd_megakernel, dim3(grid), dim3(512), args, LDS_BYTES, stream);
    if (e != hipSuccess) fprintf(stderr, "kernel_launch: cooperative launch failed: %s (grid %d)\n", hipGetErrorString(e), grid);
}
```
